# Optimizing an MI355X kernel written in HIP

```python
import jax, jax.numpy as jnp
from jax import lax
import numpy as np

D_MODEL = 4096
BATCH = 4
SEQ = 2048
DEPTH = 1

N_META = 16
MIX_WIDTH = D_MODEL
CONV_CH = MIX_WIDTH // 2
POOL_CH = MIX_WIDTH - CONV_CH
CONV_HEADS = 16
CONV_K = 3
POOL_WINDOWS = (2, 4, 8, 16)
N_POOL_GROUPS = len(POOL_WINDOWS)
POOL_GROUP = POOL_CH // N_POOL_GROUPS
IN_COLS = 3 * CONV_CH + POOL_CH
D_FF = 256 * ((8 * D_MODEL // 3 + 255) // 256)
LN_EPS = 1e-5
ALPHA = (2.0 * DEPTH) ** 0.25
BETA = (8.0 * DEPTH) ** -0.25

kernel_name = "hybrid_conv_pool_macaron_deepnorm"


def layer_norm(x, g, b):
    xf = x.astype(jnp.float32)
    mu = jnp.mean(xf, axis=-1, keepdims=True)
    xc = xf - mu
    var = jnp.mean(jnp.square(xc), axis=-1, keepdims=True)
    y = xc * lax.rsqrt(var + LN_EPS) * g.astype(jnp.float32) + b.astype(jnp.float32)
    return y.astype(x.dtype)


def swiglu_ffn(x, w_gu, w_down):
    gu = jnp.einsum('bld,df->blf', x, w_gu)
    gate, up = jnp.split(gu, 2, axis=-1)
    return jnp.einsum('blf,fd->bld', jax.nn.silu(gate) * up, w_down)


def causal_short_conv(z, w):
    L = z.shape[1]
    zp = jnp.pad(z, ((0, 0), (CONV_K - 1, 0), (0, 0)))
    y = zp[:, 0:L] * w[0]
    for k in range(1, CONV_K):
        y = y + zp[:, k:k + L] * w[k]
    return y


def causal_window_mean(z, window):
    L = z.shape[1]
    cs = jnp.cumsum(z, axis=1)
    prev = jnp.pad(cs, ((0, 0), (window, 0), (0, 0)))[:, :L]
    count = jnp.minimum(jnp.arange(1, L + 1), window).astype(jnp.float32)
    return (cs - prev) / count[None, :, None]


def pooling_mixer(z, pool_w, pool_scale):
    b, L, _ = z.shape
    zg = z.reshape(b, L, N_POOL_GROUPS, POOL_GROUP).astype(jnp.float32)
    pooled = jnp.stack([causal_window_mean(zg[:, :, g], POOL_WINDOWS[g])
                        for g in range(N_POOL_GROUPS)], axis=2)
    d = (pooled - zg).astype(z.dtype)
    y = jnp.einsum('blgc,gcd->blgd', d, pool_w).reshape(b, L, POOL_CH)
    return y * pool_scale


def hybrid_mixer(h, w_in, conv_w, pool_w, pool_scale, w_out):
    u = jnp.einsum('bld,dc->blc', h, w_in)
    gate_b = u[..., 0:CONV_CH]
    gate_c = u[..., CONV_CH:2 * CONV_CH]
    x_in = u[..., 2 * CONV_CH:3 * CONV_CH]
    z_pool = u[..., 3 * CONV_CH:]
    y_conv = gate_b * causal_short_conv(gate_c * x_in, conv_w)
    y_pool = pooling_mixer(z_pool, pool_w, pool_scale)
    y = jnp.concatenate([y_conv, y_pool], axis=-1)
    return jnp.einsum('blc,cd->bld', y, w_out)


def setup_inputs(seed: int = 0) -> dict:
    key = jax.random.key(seed)
    ks = jax.random.split(key, 20)
    f32 = jnp.float32
    D, F = D_MODEL, D_FF

    def nrm(k, shape, scale):
        return jax.random.normal(k, shape, f32) * scale

    def gain(k):
        return 1.0 + 0.05 * jax.random.normal(k, (DEPTH, D), f32)

    def bias(k):
        return 0.02 * jax.random.normal(k, (DEPTH, D), f32)

    return {
        "x": jax.random.normal(ks[0], (BATCH, SEQ, D), f32),
        "meta_tokens": nrm(ks[1], (N_META, D), 1.0),
        "ffn1_w_gu": nrm(ks[2], (DEPTH, D, 2 * F), D ** -0.5),
        "ffn1_w_down": nrm(ks[3], (DEPTH, F, D), BETA * F ** -0.5),
        "ln1_g": gain(ks[4]),
        "ln1_b": bias(ks[5]),
        "w_in": nrm(ks[6], (DEPTH, D, IN_COLS), D ** -0.5),
        "conv_w": nrm(ks[7], (DEPTH, CONV_K, CONV_CH), CONV_K ** -0.5),
        "pool_w": nrm(ks[8], (DEPTH, N_POOL_GROUPS, POOL_GROUP, POOL_GROUP), POOL_GROUP ** -0.5),
        "pool_scale": 1.0 + 0.1 * jax.random.normal(ks[9], (DEPTH, POOL_CH), f32),
        "w_out": nrm(ks[10], (DEPTH, MIX_WIDTH, D), BETA * MIX_WIDTH ** -0.5),
        "ln2_g": gain(ks[11]),
        "ln2_b": bias(ks[12]),
        "ffn2_w_gu": nrm(ks[13], (DEPTH, D, 2 * F), D ** -0.5),
        "ffn2_w_down": nrm(ks[14], (DEPTH, F, D), BETA * F ** -0.5),
        "ln3_g": gain(ks[15]),
        "ln3_b": bias(ks[16]),
    }


def reference(x, meta_tokens, ffn1_w_gu, ffn1_w_down, ln1_g, ln1_b, w_in, conv_w, pool_w,
              pool_scale, w_out, ln2_g, ln2_b, ffn2_w_gu, ffn2_w_down, ln3_g, ln3_b):
    b = x.shape[0]
    meta = jnp.broadcast_to(meta_tokens.astype(x.dtype)[None], (b, N_META, D_MODEL))
    h = jnp.concatenate([meta, x], axis=1)
    for i in range(DEPTH):
        h = layer_norm(ALPHA * h + 0.5 * swiglu_ffn(h, ffn1_w_gu[i], ffn1_w_down[i]),
                       ln1_g[i], ln1_b[i])
        h = layer_norm(ALPHA * h + hybrid_mixer(h, w_in[i], conv_w[i], pool_w[i],
                                                 pool_scale[i], w_out[i]),
                       ln2_g[i], ln2_b[i])
        h = layer_norm(ALPHA * h + 0.5 * swiglu_ffn(h, ffn2_w_gu[i], ffn2_w_down[i]),
                       ln3_g[i], ln3_b[i])
    return h[:, N_META:]
```

```cpp
#include <hip/hip_runtime.h>
#include <cstdio>
#include <cstdint>

#ifndef MK_N_LAUNCHES
#define MK_N_LAUNCHES 12
#endif

namespace pg8 {
#define PG8_LAS __attribute__((address_space(3)))
typedef unsigned short bf16_t;
typedef short bf16x8 __attribute__((ext_vector_type(8)));
typedef float f32x4 __attribute__((ext_vector_type(4)));
typedef float f32x2 __attribute__((ext_vector_type(2)));
typedef unsigned u32x4 __attribute__((ext_vector_type(4)));
typedef unsigned u32x2 __attribute__((ext_vector_type(2)));
constexpr int BM = 256, BK = 64, HALF = 128, HTB = HALF * BK * 2  , STAGE_BYTES = 8 * HTB, NXCD = 8, WGM = 8;

__host__ __device__ __forceinline__ int lds_byte(int r, int c) { const int st = (r >> 4) * 2 + (c >> 5), rr = r & 15, cc = c & 31, ob = rr * 64 + cc * 2; return st * 1024 + (ob ^ (((ob >> 9) & 1) << 5)); }
__host__ __device__ __forceinline__ void stage_rc(int b, int& R, int& C) { const int st = b / 1024, sb = b % 1024, swz = sb ^ (((sb >> 9) & 1) << 5); R = (st >> 1) * 16 + swz / 64; C = (st & 1) * 32 + (swz % 64) / 2; }
__host__ __device__ __forceinline__ int perm32(int rho) { const int n = rho >> 4, i = rho & 15; return 8 * (i >> 2) + 4 * n + (i & 3); }

struct Unit { int pm, pn; };
struct Gemm { const bf16_t* A; const bf16_t* Bt; int M, N, K, lda, ldb, agshift, agoff; };

struct StaticOrder {
    int nM, nN, nwg, G, c;
    __host__ __device__ void init(int M, int N, int G_, int c_) { nM = M / BM; nN = N / BM; nwg = nM * nN; G = G_; c = c_; }
    __host__ __device__ bool next(int i, Unit& u) const {
        const long L = (long)i * G + c; if (L >= nwg) return false;
        int wgid = (int)L; { const int q = nwg / NXCD, r = nwg % NXCD, xcd = wgid % NXCD, off = wgid / NXCD; wgid = (xcd < r ? xcd * (q + 1) : r * (q + 1) + (xcd - r) * q) + off; }
        const int nig = WGM * nN, gid = wgid / nig, fm = gid * WGM, gsz = (nM - fm) < WGM ? (nM - fm) : WGM;
        u.pm = fm + ((wgid % nig) % gsz); u.pn = (wgid % nig) / gsz; return true;
    }
    __device__ __forceinline__ void a_ready(const Unit&) const {}
    __device__ __forceinline__ void done(const Unit&) const {}
};

__device__ __forceinline__ unsigned cvt_pk_bf16(float lo, float hi) { unsigned r; asm volatile("v_cvt_pk_bf16_f32 %0, %1, %2" : "=v"(r) : "v"(lo), "v"(hi)); return r; }
__device__ __forceinline__ float silu_f(float x) { return x * __builtin_amdgcn_rcpf(1.0f + __builtin_amdgcn_exp2f(x * -1.4426950408889634f)); }

struct EpiSwiGLU {
    static constexpr bool PERM = true, AFTER_DRAIN = false;
    bf16_t* O; int ldc;
    __device__ __forceinline__ void operator()(const f32x4 (&acc)[2][2][4][2], const Unit& u, int wr, int wc, int fr, int fq) const {
        const int row0 = u.pm * BM + wr * 64 + fr, col0 = u.pn * HALF + wc * 32 + 8 * fq;
#pragma unroll
        for (int ai = 0; ai < 2; ++ai)
#pragma unroll
            for (int m = 0; m < 4; ++m) { bf16_t* p = O + (size_t)(row0 + ai * HALF + m * 16) * ldc + col0;
                const f32x4 g0 = acc[ai][0][m][0], g1 = acc[ai][0][m][1], u0 = acc[ai][1][m][0], u1 = acc[ai][1][m][1];
                u32x4 w;
                w.x = cvt_pk_bf16(silu_f(g0[0]) * u0[0], silu_f(g0[1]) * u0[1]); w.y = cvt_pk_bf16(silu_f(g0[2]) * u0[2], silu_f(g0[3]) * u0[3]);
                w.z = cvt_pk_bf16(silu_f(g1[0]) * u1[0], silu_f(g1[1]) * u1[1]); w.w = cvt_pk_bf16(silu_f(g1[2]) * u1[2], silu_f(g1[3]) * u1[3]);
                *(u32x4*)p = w; }
    }
};
struct EpiBf16S {
    static constexpr bool PERM = true, AFTER_DRAIN = false;
    bf16_t* O; int ldc; int ocol0; const float* cscale;
    __device__ __forceinline__ void operator()(const f32x4 (&acc)[2][2][4][2], const Unit& u, int wr, int wc, int fr, int fq) const {
        const int row0 = u.pm * BM + wr * 64 + fr, col0 = u.pn * BM + wc * 32 + 8 * fq;
        f32x4 sv[2][2];
#pragma unroll
        for (int bj = 0; bj < 2; ++bj)
#pragma unroll
            for (int n = 0; n < 2; ++n) sv[bj][n] = cscale ? *(const f32x4*)(cscale + col0 + bj * HALF + 4 * n) : (f32x4){1.f, 1.f, 1.f, 1.f};
#pragma unroll
        for (int ai = 0; ai < 2; ++ai)
#pragma unroll
            for (int m = 0; m < 4; ++m) { bf16_t* rowp = O + (size_t)(row0 + ai * HALF + m * 16) * ldc + ocol0 + col0;
#pragma unroll
                for (int bj = 0; bj < 2; ++bj) { const f32x4 v0 = acc[ai][bj][m][0] * sv[bj][0], v1 = acc[ai][bj][m][1] * sv[bj][1];
                    u32x4 w; w.x = cvt_pk_bf16(v0[0], v0[1]); w.y = cvt_pk_bf16(v0[2], v0[3]); w.z = cvt_pk_bf16(v1[0], v1[1]); w.w = cvt_pk_bf16(v1[2], v1[3]);
                    *(u32x4*)(rowp + bj * HALF) = w; } }
    }
};
struct EpiResid {
    static constexpr bool PERM = false, AFTER_DRAIN = false;
    const float* res; float* out; int ldc; float alpha, beta;
    __device__ __forceinline__ void operator()(const f32x4 (&acc)[2][2][4][2], const Unit& u, int wr, int wc, int fr, int fq) const {
        const int row0 = u.pm * BM + wr * 64 + fr, col0 = u.pn * BM + wc * 32 + 4 * fq;
#pragma unroll
        for (int ai = 0; ai < 2; ++ai)
#pragma unroll
            for (int m = 0; m < 4; ++m) { const size_t off = (size_t)(row0 + ai * HALF + m * 16) * ldc + col0;
                f32x4 rv[2][2];
#pragma unroll
                for (int bj = 0; bj < 2; ++bj)
#pragma unroll
                    for (int n = 0; n < 2; ++n) rv[bj][n] = *(const f32x4*)(res + off + bj * HALF + n * 16);
#pragma unroll
                for (int bj = 0; bj < 2; ++bj)
#pragma unroll
                    for (int n = 0; n < 2; ++n) *(f32x4*)(out + off + bj * HALF + n * 16) = rv[bj][n] * alpha + acc[ai][bj][m][n] * beta;
                if (m & 1) asm volatile("" ::: "memory"); }
    }
};

template <class Epi, class Sched, bool ALIGN_EPI = false, bool SP2 = false>
__device__ __forceinline__ void gemm_phase(PG8_LAS unsigned char* lds, const Gemm g, const Sched& S, const Epi& E) {
    const int tid = threadIdx.x, wid = __builtin_amdgcn_readfirstlane(tid >> 6), lane = tid & 63, wr = wid >> 2, wc = wid & 3, fr = lane & 15, fq = lane >> 4;
    const int K = g.K, nt = K / BK;
    unsigned voffA[2], voffB[2];
#pragma unroll
    for (int i = 0; i < 2; ++i) { int R, C; stage_rc(tid * 16 + i * 8192, R, C); const int Rb = Epi::PERM ? ((R & ~31) + perm32(R & 31)) : R;
        voffA[i] = (unsigned)(R * g.lda + C) * 2u; voffB[i] = (unsigned)(Rb * g.ldb + C) * 2u; }
    const size_t kstep = (size_t)(BK * 2);
    const size_t hstepA = (size_t)HALF * g.lda * 2, hstepB = (size_t)HALF * g.ldb * 2;
    const size_t tstepA = 2 * hstepA, tstepB = 2 * hstepB;
    const unsigned ldsw = (unsigned)wid * 1024u;
    const int aoff = lds_byte(wr * 64 + fr, fq * 8), boff = lds_byte(wc * 32 + fr, fq * 8);
#define PG8_SA(b, h) (((b) * 2 + (h)) * HTB)
#define PG8_SB(b, h) ((4 + (b) * 2 + (h)) * HTB)
#define PG8_STAGE(bufoff, gbase, voff) do { _Pragma("unroll") for (int _i = 0; _i < 2; ++_i) \
        __builtin_amdgcn_global_load_lds((const unsigned*)((const char*)(gbase) + (voff)[_i]), (PG8_LAS unsigned*)(lds + (bufoff) + ldsw + _i * 8192), 16, 0, 0); } while (0)
#define PG8_LDA(dst, b, h) do { _Pragma("unroll") for (int m = 0; m < 4; ++m) _Pragma("unroll") for (int k = 0; k < 2; ++k) dst[m][k] = *(const PG8_LAS bf16x8*)(lds + PG8_SA(b, h) + aoff + m * 2048 + k * 1024); } while (0)
#define PG8_LDB(dst, b, h) do { _Pragma("unroll") for (int n = 0; n < 2; ++n) _Pragma("unroll") for (int k = 0; k < 2; ++k) dst[n][k] = *(const PG8_LAS bf16x8*)(lds + PG8_SB(b, h) + boff + n * 2048 + k * 1024); } while (0)
#define PG8_MMA(ai, bj, At, Bt) do { __builtin_amdgcn_s_setprio(1); _Pragma("unroll") for (int m = 0; m < 4; ++m) _Pragma("unroll") for (int n = 0; n < 2; ++n) _Pragma("unroll") for (int k = 0; k < 2; ++k) \
        acc[ai][bj][m][n] = __builtin_amdgcn_mfma_f32_16x16x32_bf16(Bt[n][k], At[m][k], acc[ai][bj][m][n], 0, 0, 0); __builtin_amdgcn_s_setprio(0); } while (0)
#define PG8_WAIT_V(n) asm volatile("s_waitcnt vmcnt(" #n ")" ::: "memory")
#define PG8_WAIT_L(n) asm volatile("s_waitcnt lgkmcnt(" #n ")" ::: "memory")
#define PG8_BAR __builtin_amdgcn_s_barrier()
#define PG8_SCHED __builtin_amdgcn_sched_barrier(0)
#define PG8_ABASE(u) ((const char*)g.A + (size_t)(u).pm * tstepA + (size_t)(((u).pn >> g.agshift) * g.agoff) * 2)
    Unit cur, nxt; int ui = 0;
    if (!S.next(0, cur)) return;
    f32x4 acc[2][2][4][2];
#pragma unroll
    for (int a = 0; a < 2; ++a)
#pragma unroll
        for (int b = 0; b < 2; ++b)
#pragma unroll
            for (int m = 0; m < 4; ++m)
#pragma unroll
                for (int n = 0; n < 2; ++n) acc[a][b][m][n] = (f32x4){0.f, 0.f, 0.f, 0.f};
    bf16x8 At[4][2], B0[2][2], B1[2][2];
    const char* cA = PG8_ABASE(cur); const char* cB = (const char*)g.Bt + (size_t)cur.pn * tstepB;
    S.a_ready(cur);
    if constexpr (SP2) {
        PG8_STAGE(PG8_SB(0, 0), cB, voffB); PG8_STAGE(PG8_SB(0, 1), cB + hstepB, voffB); PG8_STAGE(PG8_SA(0, 0), cA, voffA); PG8_STAGE(PG8_SA(0, 1), cA + hstepA, voffA);
        if (wr == 1) PG8_BAR;
        PG8_WAIT_V(2); PG8_BAR;
        PG8_STAGE(PG8_SB(1, 0), cB + kstep, voffB); PG8_STAGE(PG8_SA(1, 0), cA + kstep, voffA); PG8_STAGE(PG8_SB(1, 1), cB + hstepB + kstep, voffB);
        PG8_WAIT_V(6); PG8_BAR;
    } else {
        PG8_STAGE(PG8_SB(0, 0), cB, voffB); PG8_STAGE(PG8_SA(0, 0), cA, voffA); PG8_STAGE(PG8_SB(0, 1), cB + hstepB, voffB); PG8_STAGE(PG8_SA(0, 1), cA + hstepA, voffA);
        if (wr == 1) PG8_BAR;
        PG8_WAIT_V(4); PG8_BAR;
        PG8_STAGE(PG8_SB(1, 0), cB + kstep, voffB); PG8_STAGE(PG8_SA(1, 0), cA + kstep, voffA); PG8_STAGE(PG8_SB(1, 1), cB + hstepB + kstep, voffB);
        PG8_WAIT_V(6); PG8_BAR;
    }
    for (;;) {
        const bool has_next = S.next(ui + 1, nxt);
        const char* nA = has_next ? PG8_ABASE(nxt) : cA; const char* nB = has_next ? (const char*)g.Bt + (size_t)nxt.pn * tstepB : cB;
        for (int t = 0; t < nt; t += 2) {
            const bool last = (t == nt - 2);
            const char* a1 = cA + (size_t)(t + 1) * kstep;
            const char* a2 = last ? nA : cA + (size_t)(t + 2) * kstep; const char* b2 = last ? nB : cB + (size_t)(t + 2) * kstep;
            const char* a3 = a2 + kstep; const char* b3 = b2 + kstep;
            if (last && has_next) S.a_ready(nxt);
            if constexpr (SP2) {
            PG8_LDB(B0, 0, 0); PG8_LDB(B1, 0, 1); PG8_SCHED; PG8_LDA(At, 0, 0); PG8_STAGE(PG8_SA(1, 1), a1 + hstepA, voffA);
            PG8_WAIT_V(8); PG8_WAIT_L(0); PG8_BAR; PG8_MMA(0, 0, At, B0); PG8_MMA(0, 1, At, B1); PG8_BAR; PG8_SCHED;
            PG8_LDA(At, 0, 1); PG8_STAGE(PG8_SB(0, 0), b2, voffB); PG8_STAGE(PG8_SB(0, 1), b2 + hstepB, voffB); PG8_STAGE(PG8_SA(0, 0), a2, voffA);
            PG8_WAIT_V(8); PG8_WAIT_L(0); PG8_BAR; PG8_MMA(1, 0, At, B0); PG8_MMA(1, 1, At, B1); PG8_BAR; PG8_SCHED;
            PG8_LDB(B0, 1, 0); PG8_LDB(B1, 1, 1); PG8_SCHED; PG8_LDA(At, 1, 0); PG8_STAGE(PG8_SA(0, 1), a2 + hstepA, voffA);
            PG8_WAIT_V(8); PG8_WAIT_L(0); PG8_BAR; PG8_MMA(0, 0, At, B0); PG8_MMA(0, 1, At, B1); PG8_BAR; PG8_SCHED;
            PG8_LDA(At, 1, 1); PG8_STAGE(PG8_SB(1, 0), b3, voffB); PG8_STAGE(PG8_SB(1, 1), b3 + hstepB, voffB); PG8_STAGE(PG8_SA(1, 0), a3, voffA);
            PG8_WAIT_V(8); PG8_WAIT_L(0); PG8_BAR; PG8_MMA(1, 0, At, B0); PG8_MMA(1, 1, At, B1); PG8_BAR; PG8_SCHED;
            } else {
            PG8_LDB(B0, 0, 0); PG8_SCHED; PG8_LDA(At, 0, 0); PG8_STAGE(PG8_SA(1, 1), a1 + hstepA, voffA);
            PG8_WAIT_L(8); PG8_BAR; PG8_WAIT_L(0); PG8_MMA(0, 0, At, B0); PG8_BAR; PG8_SCHED;
            PG8_LDB(B1, 0, 1); PG8_STAGE(PG8_SB(0, 0), b2, voffB);
            PG8_BAR; PG8_WAIT_L(0); PG8_MMA(0, 1, At, B1); PG8_BAR;
            PG8_LDA(At, 0, 1); PG8_STAGE(PG8_SA(0, 0), a2, voffA);
            PG8_BAR; PG8_WAIT_L(0); PG8_MMA(1, 0, At, B0); PG8_BAR; PG8_SCHED;
            PG8_STAGE(PG8_SB(0, 1), b2 + hstepB, voffB);
            PG8_WAIT_V(6); PG8_BAR; PG8_MMA(1, 1, At, B1); PG8_BAR;
            PG8_LDB(B0, 1, 0); PG8_SCHED; PG8_LDA(At, 1, 0); PG8_STAGE(PG8_SA(0, 1), a2 + hstepA, voffA);
            PG8_WAIT_L(8); PG8_BAR; PG8_WAIT_L(0); PG8_MMA(0, 0, At, B0); PG8_BAR; PG8_SCHED;
            PG8_LDB(B1, 1, 1); PG8_STAGE(PG8_SB(1, 0), b3, voffB);
            PG8_BAR; PG8_WAIT_L(0); PG8_MMA(0, 1, At, B1); PG8_BAR;
            PG8_LDA(At, 1, 1); PG8_STAGE(PG8_SA(1, 0), a3, voffA);
            PG8_BAR; PG8_WAIT_L(0); PG8_MMA(1, 0, At, B0); PG8_BAR; PG8_SCHED;
            PG8_STAGE(PG8_SB(1, 1), b3 + hstepB, voffB);
            PG8_WAIT_V(6); PG8_BAR; PG8_MMA(1, 1, At, B1); PG8_BAR;
            }
        }
        if constexpr (ALIGN_EPI) { if (wr == 0) PG8_BAR; }
        if constexpr (!Epi::AFTER_DRAIN) { E(acc, cur, wr, wc, fr, fq); S.done(cur); }
        if (!has_next) break;
#pragma unroll
        for (int a = 0; a < 2; ++a)
#pragma unroll
            for (int b = 0; b < 2; ++b)
#pragma unroll
                for (int m = 0; m < 4; ++m)
#pragma unroll
                    for (int n = 0; n < 2; ++n) acc[a][b][m][n] = (f32x4){0.f, 0.f, 0.f, 0.f};
        cur = nxt; cA = nA; cB = nB; ++ui;
        if constexpr (ALIGN_EPI) { if (wr == 1) PG8_BAR; }
    }
    PG8_WAIT_V(0);
    if constexpr (!ALIGN_EPI) { if (wr == 0) PG8_BAR; }
    PG8_BAR;
#undef PG8_SA
#undef PG8_SB
#undef PG8_STAGE
#undef PG8_LDA
#undef PG8_LDB
#undef PG8_MMA
#undef PG8_WAIT_V
#undef PG8_WAIT_L
#undef PG8_BAR
#undef PG8_SCHED
#undef PG8_ABASE
}
}

constexpr int NWAVES = 8;
constexpr int N_LAUNCHES = MK_N_LAUNCHES;
constexpr int PER_PHASE = 12;

constexpr int D = 4096, NB = 4, SEQ = 2048, NMETA = 16, FF = 11008, CONVC = 2048, POOLC = 2048, PG = 512, INC = 8192;
constexpr int M = NB * SEQ;
constexpr int MR = M + NMETA;
constexpr float LN_EPS = 1e-5f;
constexpr float ALPHA = 1.189207115002721f;

constexpr size_t MiB = 1u << 20;
constexpr size_t WS_CTL = 0, CTL_ZERO_BYTES = 1 * MiB;
constexpr size_t WS_WGU1 = 2 * MiB, WS_WD1 = 174 * MiB, WS_WIN = 260 * MiB, WS_WPOOL = 324 * MiB, WS_WOUT = 326 * MiB, WS_WGU2 = 358 * MiB, WS_WD2 = 530 * MiB;
constexpr size_t WS_HB = 616 * MiB;
constexpr size_t WS_R = 681 * MiB;
constexpr size_t WS_ACT = 811 * MiB;
constexpr size_t WS_U = WS_ACT, WS_DP = 941 * MiB;
constexpr size_t WS_Y = 984 * MiB;
constexpr size_t WS_END = 1048 * MiB;
static_assert(WS_WGU1 + (size_t)2 * FF * D * 2 <= WS_WD1 && WS_WD1 + (size_t)D * FF * 2 <= WS_WIN && WS_WIN + (size_t)INC * D * 2 <= WS_WPOOL && WS_WPOOL + (size_t)POOLC * PG * 2 <= WS_WOUT &&
              WS_WOUT + (size_t)D * D * 2 <= WS_WGU2 && WS_WGU2 + (size_t)2 * FF * D * 2 <= WS_WD2 && WS_WD2 + (size_t)D * FF * 2 <= WS_HB && WS_HB + (size_t)MR * D * 2 <= WS_R &&
              WS_R + (size_t)MR * D * 4 <= WS_ACT && WS_U + (size_t)MR * INC * 2 <= WS_DP && WS_DP + (size_t)M * POOLC * 2 <= WS_Y && WS_ACT + (size_t)MR * FF * 2 <= WS_Y && WS_Y + (size_t)M * D * 2 <= WS_END, "d_ws map");
constexpr int CW_BAR = 4096;

constexpr int RING_OFF = 0, RING_BYTES = 131072;
constexpr int SCR_PER_WAVE = 64 * 65 * 4;
constexpr int MISC_OFF = 8 * SCR_PER_WAVE;
constexpr int LDS_BYTES = MISC_OFF + 1024;
static_assert(MISC_OFF >= RING_BYTES && (MISC_OFF % 16) == 0, "LDS map");

#define GAS __attribute__((address_space(1)))
#define LAS __attribute__((address_space(3)))
typedef unsigned short bf16;
typedef unsigned v4u __attribute__((ext_vector_type(4)));
typedef unsigned v2u __attribute__((ext_vector_type(2)));
typedef float f32x4 __attribute__((ext_vector_type(4)));
typedef short bf16x8 __attribute__((ext_vector_type(8)));
typedef GAS unsigned gu32;
#define RLX_AGENT __ATOMIC_RELAXED, __HIP_MEMORY_SCOPE_AGENT
#define LDS_WAIT() asm volatile("s_waitcnt lgkmcnt(0)" ::: "memory")
#define VM_WAIT() asm volatile("s_waitcnt vmcnt(0)" ::: "memory")
__device__ __forceinline__ unsigned pk2(float lo, float hi) { return pg8::cvt_pk_bf16(lo, hi); }
__device__ __forceinline__ float bf_lo(unsigned u) { return __uint_as_float(u << 16); }
__device__ __forceinline__ float bf_hi(unsigned u) { return __uint_as_float(u & 0xffff0000u); }

#define XB_TMO      128
#define XB_XCNT(j)  (256  + 64 * (j))
#define XB_XSUB(j)  (1280 + 64 * (j))
#define XB_XGEN(j)  (2304 + 64 * (j))
#define XB_TOP      3328
#define XB_TOPGEN   3392
#define XCD_BAR_WORDS 3456
#define XB_SPIN_CAP (1u << 18)

__device__ __forceinline__ unsigned xb_ld(unsigned* p)              { return __hip_atomic_load(p, __ATOMIC_RELAXED, __HIP_MEMORY_SCOPE_AGENT); }
__device__ __forceinline__ unsigned xb_add(unsigned* p, unsigned v) { return __hip_atomic_fetch_add(p, v, __ATOMIC_RELAXED, __HIP_MEMORY_SCOPE_AGENT); }
__device__ __forceinline__ unsigned xb_xcc_id() { return (unsigned)__builtin_amdgcn_s_getreg((3 << 11) | 20) & 0xFu; }
#define XB_SPIN(cond, bar) do { unsigned _sp = 0; while (cond) { __builtin_amdgcn_s_sleep(1); \
    if ((++_sp & 255u) == 0u) { if (xb_ld(&(bar)[XB_TMO])) break; if (_sp > XB_SPIN_CAP) { atomicAdd(&(bar)[XB_TMO], 1u); break; } } } } while (0)

struct XcdBarrier {
    unsigned* bar; unsigned x;
    volatile LAS unsigned* st;
};
__device__ __forceinline__ XcdBarrier xcd_barrier_post(unsigned* bar, volatile LAS unsigned* st) {
    XcdBarrier b; b.bar = bar; b.x = xb_xcc_id(); b.st = st;
    if (threadIdx.x == 0) (void)xb_add(&bar[XB_XCNT(b.x)], 1u);
    return b;
}
__device__ __forceinline__ void xcd_barrier_complete(unsigned* bar, unsigned x, unsigned& nloc, unsigned& nx) {
    const unsigned G = gridDim.x * gridDim.y * gridDim.z;
    unsigned sum, cnt, mine, sp = 0u;
    for (;;) {
        sum = 0u; cnt = 0u; mine = 0u;
#pragma unroll
        for (unsigned j = 0; j < 16; ++j) { const unsigned c = xb_ld(&bar[XB_XCNT(j)]); sum += c; cnt += (c > 0u) ? 1u : 0u; mine = (j == x) ? c : mine; }
        if (sum == G) break;
        __builtin_amdgcn_s_sleep(1);
        if ((++sp & 255u) == 0u) { if (xb_ld(&bar[XB_TMO])) break; if (sp > XB_SPIN_CAP) { atomicAdd(&bar[XB_TMO], 1u); break; } }
    }
    nloc = mine > 0u ? mine : 1u; nx = cnt > 0u ? cnt : 1u;
}
__device__ __forceinline__ void xcd_barrier(const XcdBarrier& b) {
    asm volatile("s_waitcnt vmcnt(0)" ::: "memory");
    __syncthreads();
    if (threadIdx.x == 0) {
        unsigned* bar = b.bar;
        __builtin_amdgcn_s_waitcnt(0);
        unsigned nloc = b.st[0], nx = b.st[1];
        if (nloc == 0u) { xcd_barrier_complete(bar, b.x, nloc, nx); b.st[0] = nloc; b.st[1] = nx; }
        const unsigned old = xb_add(&bar[XB_XSUB(b.x)], 1u);
        const unsigned gen = old / nloc;
        if (old + 1u == (gen + 1u) * nloc) {
            __builtin_amdgcn_fence(__ATOMIC_RELEASE, "agent");
            asm volatile("s_waitcnt vmcnt(0)" ::: "memory");
            const unsigned og = xb_add(&bar[XB_TOP], 1u);
            const unsigned tg = og / nx;
            if (og + 1u == (tg + 1u) * nx) xb_add(&bar[XB_TOPGEN], 1u);
            else XB_SPIN(xb_ld(&bar[XB_TOPGEN]) == tg, bar);
            __builtin_amdgcn_fence(__ATOMIC_ACQUIRE, "agent");
            xb_add(&bar[XB_XGEN(b.x)], 1u);
            asm volatile("s_waitcnt vmcnt(0)" ::: "memory");
        } else {
            XB_SPIN(xb_ld(&bar[XB_XGEN(b.x)]) == gen, bar);
            __builtin_amdgcn_fence(__ATOMIC_ACQUIRE, "agent");
            asm volatile("s_waitcnt vmcnt(0)" ::: "memory");
        }
    }
    __syncthreads();
}

struct Frame {
    LAS unsigned char* lds;
    volatile LAS unsigned* MISC;
    gu32* ctl;
    int tid, lane, wave;
    int vcu, G;
    const float *x, *meta, *w_gu1, *w_d1, *ln1g, *ln1b, *w_in, *conv_w, *pool_w, *pool_scale, *w_out, *ln2g, *ln2b, *w_gu2, *w_d2, *ln3g, *ln3b;
    float* out;
    bf16 *Wgu1, *Wd1, *Win, *Wpool, *Wout, *Wgu2, *Wd2;
    bf16 *HB, *ACT, *U, *DP, *Y;
    float* R;
};

__device__ __forceinline__ float wave_sum(float v) {
#pragma unroll
    for (int o = 1; o < 64; o <<= 1) v += __shfl_xor(v, o);
    return v;
}

template <int MODE>
__device__ __forceinline__ void p0_transpose_item(const float* __restrict__ W, int K, int N, bf16* __restrict__ WT, LAS float* scr, int item, int lane) {
    const int nblk = N / 64, kb = item / nblk, nb = item % nblk, k0 = 64 * kb, n0 = 64 * nb;
    const int r4 = lane >> 4, c16 = lane & 15;
    f32x4 v[16];
#pragma unroll
    for (int i = 0; i < 16; ++i) v[i] = *(const f32x4*)(W + (size_t)(k0 + 4 * i + r4) * N + n0 + 4 * c16);
#pragma unroll
    for (int i = 0; i < 16; ++i) { LAS float* s = scr + (4 * i + r4) * 65 + 4 * c16; s[0] = v[i][0]; s[1] = v[i][1]; s[2] = v[i][2]; s[3] = v[i][3]; }
    LDS_WAIT(); asm volatile("" ::: "memory");
    int drow0;
    if (MODE == 1) { const int nn = n0 < FF ? n0 : n0 - FF; drow0 = 256 * (nn >> 7) + (nn & 127) + (n0 < FF ? 0 : 128); } else drow0 = n0;
    const int c = lane & 7, nl = lane >> 3;
#pragma unroll
    for (int j = 0; j < 8; ++j) { const int n = nl + 8 * j; const LAS float* s = scr + (8 * c) * 65 + n;
        v4u o; o.x = pk2(s[0 * 65], s[1 * 65]); o.y = pk2(s[2 * 65], s[3 * 65]); o.z = pk2(s[4 * 65], s[5 * 65]); o.w = pk2(s[6 * 65], s[7 * 65]);
        *(v4u*)(WT + (size_t)(drow0 + n) * K + k0 + 8 * c) = o; }
    LDS_WAIT(); asm volatile("" ::: "memory");
}
__device__ __forceinline__ void p0_prologue(Frame& F) {
    LAS float* scr = (LAS float*)(F.lds + F.wave * SCR_PER_WAVE);
    const int gw = F.vcu * NWAVES + F.wave, NGW = F.G * NWAVES;
    constexpr int I_GU = (D / 64) * (2 * FF / 64), I_D = (FF / 64) * (D / 64), I_IN = (D / 64) * (INC / 64), I_OUT = (D / 64) * (D / 64), I_PL = (PG / 64) * (PG / 64);
    constexpr int NITEMS = 2 * I_GU + 2 * I_D + I_IN + I_OUT + 4 * I_PL;
    for (int it = gw; it < NITEMS; it += NGW) {
        int r = it;
        if (r < I_GU) { p0_transpose_item<1>(F.w_gu1, D, 2 * FF, F.Wgu1, scr, r, F.lane); continue; } r -= I_GU;
        if (r < I_D) { p0_transpose_item<0>(F.w_d1, FF, D, F.Wd1, scr, r, F.lane); continue; } r -= I_D;
        if (r < I_IN) { p0_transpose_item<0>(F.w_in, D, INC, F.Win, scr, r, F.lane); continue; } r -= I_IN;
        if (r < 4 * I_PL) { const int g = r / I_PL; p0_transpose_item<0>(F.pool_w + (size_t)g * PG * PG, PG, PG, F.Wpool + (size_t)g * PG * PG, scr, r % I_PL, F.lane); continue; } r -= 4 * I_PL;
        if (r < I_OUT) { p0_transpose_item<0>(F.w_out, D, D, F.Wout, scr, r, F.lane); continue; } r -= I_OUT;
        if (r < I_GU) { p0_transpose_item<1>(F.w_gu2, D, 2 * FF, F.Wgu2, scr, r, F.lane); continue; } r -= I_GU;
        p0_transpose_item<0>(F.w_d2, FF, D, F.Wd2, scr, r, F.lane);
    }
    const size_t tot8 = (size_t)MR * D / 8, gt = (size_t)(F.vcu * NWAVES + F.wave) * 64 + F.lane, nthr = (size_t)NGW * 64;
    for (size_t i = gt; i < tot8; i += nthr) {
        const size_t e = i * 8; const float* src = e < (size_t)M * D ? F.x + e : F.meta + (e - (size_t)M * D);
        const f32x4 a = *(const f32x4*)src, b = *(const f32x4*)(src + 4);
        v4u o; o.x = pk2(a[0], a[1]); o.y = pk2(a[2], a[3]); o.z = pk2(b[0], b[1]); o.w = pk2(b[2], b[3]);
        *(v4u*)(F.HB + e) = o;
    }
}

__device__ __forceinline__ f32x4 skinny_partial(const bf16* __restrict__ Arow, const bf16* __restrict__ Brow, int nsteps) {
    f32x4 acc = (f32x4){0.f, 0.f, 0.f, 0.f};
#pragma unroll 8
    for (int s = 0; s < nsteps; ++s) {
        const bf16x8 a = *(const bf16x8*)(Arow + 32 * s), b = *(const bf16x8*)(Brow + 32 * s);
        acc = __builtin_amdgcn_mfma_f32_16x16x32_bf16(b, a, acc, 0, 0, 0);
    }
    return acc;
}
__device__ __forceinline__ void meta_gu(Frame& F, const bf16* Wgu) {
    LAS f32x4* red = (LAS f32x4*)F.lds;
    const int fr = F.lane & 15, fq = F.lane >> 4, half = F.wave >> 2, kq = F.wave & 3;
    for (int it = F.vcu; it < FF / 16; it += F.G) {
        const int j = 16 * it, brow = 256 * (j >> 7) + (j & 127) + 128 * half;
        const f32x4 p = skinny_partial(F.HB + (size_t)(M + fr) * D + 1024 * kq + 8 * fq, Wgu + (size_t)(brow + fr) * D + 1024 * kq + 8 * fq, 32);
        red[F.wave * 64 + F.lane] = p;
        __syncthreads();
        if (F.wave == 0) {
            const f32x4 g = (red[F.lane] + red[64 + F.lane]) + (red[128 + F.lane] + red[192 + F.lane]);
            const f32x4 u = (red[256 + F.lane] + red[320 + F.lane]) + (red[384 + F.lane] + red[448 + F.lane]);
            v2u o; o.x = pk2(pg8::silu_f(g[0]) * u[0], pg8::silu_f(g[1]) * u[1]); o.y = pk2(pg8::silu_f(g[2]) * u[2], pg8::silu_f(g[3]) * u[3]);
            *(v2u*)(F.ACT + (size_t)(M + fr) * FF + j + 4 * fq) = o;
        }
        __syncthreads();
    }
}
__device__ __forceinline__ void meta_down(Frame& F, const bf16* Wd) {
    LAS f32x4* red = (LAS f32x4*)F.lds;
    const int fr = F.lane & 15, fq = F.lane >> 4;
    for (int it = F.vcu; it < D / 16; it += F.G) {
        const int n0 = 16 * it, kb = (FF / 8) * F.wave;
        const f32x4 p = skinny_partial(F.ACT + (size_t)(M + fr) * FF + kb + 8 * fq, Wd + (size_t)(n0 + fr) * FF + kb + 8 * fq, FF / 8 / 32);
        red[F.wave * 64 + F.lane] = p;
        __syncthreads();
        if (F.wave == 0) {
            const f32x4 s = ((red[F.lane] + red[64 + F.lane]) + (red[128 + F.lane] + red[192 + F.lane])) + ((red[256 + F.lane] + red[320 + F.lane]) + (red[384 + F.lane] + red[448 + F.lane]));
            const f32x4 mv = *(const f32x4*)(F.meta + (size_t)fr * D + n0 + 4 * fq);
            *(f32x4*)(F.R + (size_t)(M + fr) * D + n0 + 4 * fq) = mv * ALPHA + s * 0.5f;
        }
        __syncthreads();
    }
}
__device__ __forceinline__ void meta_win(Frame& F) {
    LAS f32x4* red = (LAS f32x4*)F.lds;
    const int fr = F.lane & 15, fq = F.lane >> 4;
    for (int it = F.vcu; it < INC / 16; it += F.G) {
        const int n0 = 16 * it, kb = (D / 8) * F.wave;
        const f32x4 p = skinny_partial(F.HB + (size_t)(M + fr) * D + kb + 8 * fq, F.Win + (size_t)(n0 + fr) * D + kb + 8 * fq, D / 8 / 32);
        red[F.wave * 64 + F.lane] = p;
        __syncthreads();
        if (F.wave == 0) {
            const f32x4 s = ((red[F.lane] + red[64 + F.lane]) + (red[128 + F.lane] + red[192 + F.lane])) + ((red[256 + F.lane] + red[320 + F.lane]) + (red[384 + F.lane] + red[448 + F.lane]));
            v2u o; o.x = pk2(s[0], s[1]); o.y = pk2(s[2], s[3]);
            *(v2u*)(F.U + (size_t)(M + fr) * INC + n0 + 4 * fq) = o;
        }
        __syncthreads();
    }
}

__device__ __forceinline__ void ln_rows(Frame& F, const float* src, int nrows, const float* __restrict__ g, const float* __restrict__ b, bf16* hb, float* dstf) {
    const int gw = F.vcu * NWAVES + F.wave, NGW = F.G * NWAVES;
    for (int row = gw; row < nrows; row += NGW) {
        const f32x4* xr = (const f32x4*)(src + (size_t)row * D) + F.lane;
        f32x4 v[16]; float s = 0.f;
#pragma unroll
        for (int j = 0; j < 16; ++j) { v[j] = xr[64 * j]; s += (v[j][0] + v[j][1]) + (v[j][2] + v[j][3]); }
        const float mean = wave_sum(s) * (1.f / D); float s2 = 0.f;
#pragma unroll
        for (int j = 0; j < 16; ++j) { v[j] = v[j] - mean; s2 += (v[j][0] * v[j][0] + v[j][1] * v[j][1]) + (v[j][2] * v[j][2] + v[j][3] * v[j][3]); }
        const float rstd = 1.f / sqrtf(wave_sum(s2) * (1.f / D) + LN_EPS);
        f32x4* of = (f32x4*)(dstf + (size_t)row * D) + F.lane;
        v2u* ob = hb ? (v2u*)(hb + (size_t)row * D) + F.lane : nullptr;
#pragma unroll
        for (int j = 0; j < 16; ++j) {
            const f32x4 gg = ((const f32x4*)g)[F.lane + 64 * j], bb = ((const f32x4*)b)[F.lane + 64 * j];
            const f32x4 y = v[j] * rstd * gg + bb;
            of[64 * j] = y;
            if (hb) { v2u o; o.x = pk2(y[0], y[1]); o.y = pk2(y[2], y[3]); ob[64 * j] = o; }
        }
    }
}

__device__ __forceinline__ size_t urow(int b, int t) { return (size_t)(t >= 0 ? b * SEQ + t : MR + t); }
__device__ __forceinline__ void unpack8(const v4u p, float (&f)[8]) { f[0] = bf_lo(p.x); f[1] = bf_hi(p.x); f[2] = bf_lo(p.y); f[3] = bf_hi(p.y); f[4] = bf_lo(p.z); f[5] = bf_hi(p.z); f[6] = bf_lo(p.w); f[7] = bf_hi(p.w); }
__device__ __forceinline__ void conv_item(const bf16* __restrict__ U, bf16* __restrict__ Y, const float* __restrict__ cw, int rb, int cc, int lane) {
    const int r0 = 4 * rb, b = r0 >> 11, t0 = r0 & (SEQ - 1), c0 = 512 * cc + 8 * lane;
    v4u gc[6], xi[6], gb[4];
#pragma unroll
    for (int i = 0; i < 6; ++i) { const bf16* p = U + urow(b, t0 - 2 + i) * INC + c0; gc[i] = *(const v4u*)(p + CONVC); xi[i] = *(const v4u*)(p + 2 * CONVC); }
#pragma unroll
    for (int i = 0; i < 4; ++i) gb[i] = *(const v4u*)(U + (size_t)(r0 + i) * INC + c0);
    float w0[8], w1[8], w2[8];
#pragma unroll
    for (int e = 0; e < 8; ++e) { w0[e] = cw[c0 + e]; w1[e] = cw[CONVC + c0 + e]; w2[e] = cw[2 * CONVC + c0 + e]; }
    float q[6][8];
#pragma unroll
    for (int i = 0; i < 6; ++i) { float a[8], c[8]; unpack8(gc[i], a); unpack8(xi[i], c);
#pragma unroll
        for (int e = 0; e < 8; ++e) q[i][e] = a[e] * c[e]; }
#pragma unroll
    for (int i = 0; i < 4; ++i) { float gbf[8], y[8]; unpack8(gb[i], gbf);
#pragma unroll
        for (int e = 0; e < 8; ++e) y[e] = gbf[e] * ((w0[e] * q[i][e] + w1[e] * q[i + 1][e]) + w2[e] * q[i + 2][e]);
        v4u o; o.x = pk2(y[0], y[1]); o.y = pk2(y[2], y[3]); o.z = pk2(y[4], y[5]); o.w = pk2(y[6], y[7]);
        *(v4u*)(Y + (size_t)(r0 + i) * D + c0) = o; }
}
template <int W>
__device__ __forceinline__ void pool_item(const bf16* __restrict__ U, bf16* __restrict__ DP, int rb, int g, int lane) {
    const int r0 = 16 * rb, b = r0 >> 11, t0 = r0 & (SEQ - 1), c0 = 512 * g + 8 * lane;
    constexpr int NR = 15 + W;
    v4u z[NR];
#pragma unroll
    for (int i = 0; i < NR; ++i) z[i] = *(const v4u*)(U + urow(b, t0 - (W - 1) + i) * INC + 3 * CONVC + c0);
    float S[8];
#pragma unroll
    for (int e = 0; e < 8; ++e) S[e] = 0.f;
#pragma unroll
    for (int i = 0; i < W - 1; ++i) { float f[8]; unpack8(z[i], f);
#pragma unroll
        for (int e = 0; e < 8; ++e) S[e] += f[e]; }
#pragma unroll
    for (int i = 0; i < 16; ++i) { float f[8], fo[8], d[8]; unpack8(z[W - 1 + i], f); unpack8(z[i], fo);
#pragma unroll
        for (int e = 0; e < 8; ++e) { S[e] += f[e]; d[e] = S[e] * (1.0f / W) - f[e]; S[e] -= fo[e]; }
        v4u o; o.x = pk2(d[0], d[1]); o.y = pk2(d[2], d[3]); o.z = pk2(d[4], d[5]); o.w = pk2(d[6], d[7]);
        *(v4u*)(DP + (size_t)(r0 + i) * POOLC + c0) = o; }
}
__device__ __forceinline__ void p5_mixer(Frame& F) {
    const int gw = F.vcu * NWAVES + F.wave, NGW = F.G * NWAVES;
    constexpr int N_CONV = (M / 4) * 4, N_POOL = (M / 16) * 4;
    for (int it = gw; it < N_CONV; it += NGW) conv_item(F.U, F.Y, F.conv_w, it >> 2, it & 3, F.lane);
    for (int it = gw; it < N_POOL; it += NGW) {
        const int g = it & 3, rb = it >> 2;
        if (g == 0) pool_item<2>(F.U, F.DP, rb, 0, F.lane);
        else if (g == 1) pool_item<4>(F.U, F.DP, rb, 1, F.lane);
        else if (g == 2) pool_item<8>(F.U, F.DP, rb, 2, F.lane);
        else pool_item<16>(F.U, F.DP, rb, 3, F.lane);
    }
}

struct Args { const float* in[17]; float* out; unsigned char* ws; int ph_lo, ph_hi; };
__global__ void __launch_bounds__(NWAVES * 64, 2) mk_fwd(Args args) {
    extern __shared__ __attribute__((aligned(16))) unsigned char lds[];
    Frame F;
    F.lds = (LAS unsigned char*)lds;
    F.MISC = (volatile LAS unsigned*)(F.lds + MISC_OFF);
    F.tid = threadIdx.x; F.lane = F.tid & 63; F.wave = __builtin_amdgcn_readfirstlane(F.tid >> 6);
    F.G = gridDim.x; { const int bx = blockIdx.x; F.vcu = (F.G % 8 == 0) ? (bx % 8) * (F.G / 8) + bx / 8 : bx; }
    unsigned char* ws = args.ws;
    F.ctl = (gu32*)(ws + WS_CTL);
    F.x = args.in[0]; F.meta = args.in[1]; F.w_gu1 = args.in[2]; F.w_d1 = args.in[3]; F.ln1g = args.in[4]; F.ln1b = args.in[5]; F.w_in = args.in[6]; F.conv_w = args.in[7];
    F.pool_w = args.in[8]; F.pool_scale = args.in[9]; F.w_out = args.in[10]; F.ln2g = args.in[11]; F.ln2b = args.in[12]; F.w_gu2 = args.in[13]; F.w_d2 = args.in[14]; F.ln3g = args.in[15]; F.ln3b = args.in[16];
    F.out = args.out;
    F.Wgu1 = (bf16*)(ws + WS_WGU1); F.Wd1 = (bf16*)(ws + WS_WD1); F.Win = (bf16*)(ws + WS_WIN); F.Wpool = (bf16*)(ws + WS_WPOOL); F.Wout = (bf16*)(ws + WS_WOUT); F.Wgu2 = (bf16*)(ws + WS_WGU2); F.Wd2 = (bf16*)(ws + WS_WD2);
    F.HB = (bf16*)(ws + WS_HB); F.R = (float*)(ws + WS_R); F.ACT = (bf16*)(ws + WS_ACT); F.U = (bf16*)(ws + WS_U); F.DP = (bf16*)(ws + WS_DP); F.Y = (bf16*)(ws + WS_Y);
    for (int u = F.tid; u < (LDS_BYTES - MISC_OFF) / 4; u += NWAVES * 64) ((LAS unsigned*)(F.lds + MISC_OFF))[u] = 0u;
    __syncthreads();
    XcdBarrier bar; bar.bar = (unsigned*)(F.ctl + CW_BAR); bar.x = 0; bar.st = nullptr;
    if (N_LAUNCHES != PER_PHASE) bar = xcd_barrier_post((unsigned*)(F.ctl + CW_BAR), F.MISC + 8);
#define GRID_BAR() do { if (N_LAUNCHES != PER_PHASE) xcd_barrier(bar); } while (0)
    const int lo = args.ph_lo, hi = args.ph_hi;
#define IN(k) (lo <= (k) && (k) < hi)
#define BOTH(k) (IN(k) && IN((k) + 1))
    constexpr int BIG = 30;

    if (IN(0)) { p0_prologue(F); if (BOTH(0)) GRID_BAR(); }

    if (IN(1)) {
        meta_gu(F, F.Wgu1);
        pg8::Gemm g{F.HB, F.Wgu1, M, 2 * FF, D, D, D, BIG, 0}; pg8::StaticOrder S; S.init(M, 2 * FF, F.G, (int)blockIdx.x);
        pg8::EpiSwiGLU E{F.ACT, FF};
        pg8::gemm_phase<pg8::EpiSwiGLU, pg8::StaticOrder, true, true>(F.lds + RING_OFF, g, S, E);
        if (BOTH(1)) GRID_BAR();
    }
    if (IN(2)) {
        meta_down(F, F.Wd1);
        pg8::Gemm g{F.ACT, F.Wd1, M, D, FF, FF, FF, BIG, 0}; pg8::StaticOrder S; S.init(M, D, F.G, (int)blockIdx.x);
        pg8::EpiResid E{F.x, F.R, D, ALPHA, 0.5f};
        pg8::gemm_phase<pg8::EpiResid, pg8::StaticOrder, true, true>(F.lds + RING_OFF, g, S, E);
        if (BOTH(2)) GRID_BAR();
    }
    if (IN(3)) { ln_rows(F, F.R, MR, F.ln1g, F.ln1b, F.HB, F.R); if (BOTH(3)) GRID_BAR(); }
    if (IN(4)) {
        meta_win(F);
        pg8::Gemm g{F.HB, F.Win, M, INC, D, D, D, BIG, 0}; pg8::StaticOrder S; S.init(M, INC, F.G, (int)blockIdx.x);
        pg8::EpiBf16S E{F.U, INC, 0, nullptr};
        pg8::gemm_phase<pg8::EpiBf16S, pg8::StaticOrder, true, true>(F.lds + RING_OFF, g, S, E);
        if (BOTH(4)) GRID_BAR();
    }
    if (IN(5)) { p5_mixer(F); if (BOTH(5)) GRID_BAR(); }
    if (IN(6)) {
        pg8::Gemm g{F.DP, F.Wpool, M, POOLC, PG, POOLC, PG, 1, PG}; pg8::StaticOrder S; S.init(M, POOLC, F.G, (int)blockIdx.x);
        pg8::EpiBf16S E{F.Y, D, CONVC, F.pool_scale};
        pg8::gemm_phase<pg8::EpiBf16S, pg8::StaticOrder, true, true>(F.lds + RING_OFF, g, S, E);
        if (BOTH(6)) GRID_BAR();
    }
    if (IN(7)) {
        pg8::Gemm g{F.Y, F.Wout, M, D, D, D, D, BIG, 0}; pg8::StaticOrder S; S.init(M, D, F.G, (int)blockIdx.x);
        pg8::EpiResid E{F.R, F.R, D, ALPHA, 1.0f};
        pg8::gemm_phase<pg8::EpiResid, pg8::StaticOrder, true, true>(F.lds + RING_OFF, g, S, E);
        if (BOTH(7)) GRID_BAR();
    }
    if (IN(8)) { ln_rows(F, F.R, M, F.ln2g, F.ln2b, F.HB, F.R); if (BOTH(8)) GRID_BAR(); }
    if (IN(9)) {
        pg8::Gemm g{F.HB, F.Wgu2, M, 2 * FF, D, D, D, BIG, 0}; pg8::StaticOrder S; S.init(M, 2 * FF, F.G, (int)blockIdx.x);
        pg8::EpiSwiGLU E{F.ACT, FF};
        pg8::gemm_phase<pg8::EpiSwiGLU, pg8::StaticOrder, true, true>(F.lds + RING_OFF, g, S, E);
        if (BOTH(9)) GRID_BAR();
    }
    if (IN(10)) {
        pg8::Gemm g{F.ACT, F.Wd2, M, D, FF, FF, FF, BIG, 0}; pg8::StaticOrder S; S.init(M, D, F.G, (int)blockIdx.x);
        pg8::EpiResid E{F.R, F.R, D, ALPHA, 0.5f};
        pg8::gemm_phase<pg8::EpiResid, pg8::StaticOrder, true, true>(F.lds + RING_OFF, g, S, E);
        if (BOTH(10)) GRID_BAR();
    }
    if (IN(11)) { ln_rows(F, F.R, M, F.ln3g, F.ln3b, nullptr, F.out); }
#undef IN
#undef BOTH
#undef GRID_BAR
}

extern "C" void kernel_launch(void* const* d_in, const int* in_sizes, int n_in, void* d_out, int out_size, void* d_ws, size_t ws_size, hipStream_t stream) {
    static int grid = 0;
    if (grid == 0) {
        if (n_in != 17 || in_sizes[0] != M * D || out_size != M * D || ws_size < WS_END) { fprintf(stderr, "kernel_launch: unexpected shapes (n_in %d, in0 %d, out %d, ws %zu); nothing launched\n", n_in, n_in > 0 ? in_sizes[0] : -1, out_size, ws_size); grid = -1; return; }
        int dev = 0, cus = 0, per_cu = 0;
        if (hipGetDevice(&dev) != hipSuccess || hipDeviceGetAttribute(&cus, hipDeviceAttributeMultiprocessorCount, dev) != hipSuccess) { grid = -1; return; }
        if (hipFuncSetAttribute((const void*)mk_fwd, hipFuncAttributeMaxDynamicSharedMemorySize, LDS_BYTES) != hipSuccess) { fprintf(stderr, "kernel_launch: hipFuncSetAttribute failed\n"); grid = -1; return; }
        if (hipOccupancyMaxActiveBlocksPerMultiprocessor(&per_cu, (const void*)mk_fwd, NWAVES * 64, LDS_BYTES) != hipSuccess || per_cu < 1)
            fprintf(stderr, "kernel_launch: note: occupancy query reports %d workgroups per CU\n", per_cu);
        (void)hipGetLastError();
        grid = cus;
    }
    if (grid < 0) return;
    if (hipMemsetAsync((char*)d_ws + WS_CTL, 0, CTL_ZERO_BYTES, stream) != hipSuccess) { fprintf(stderr, "kernel_launch: hipMemsetAsync failed\n"); return; }
    Args a{};
    for (int i = 0; i < 17; ++i) a.in[i] = (const float*)d_in[i];
    a.out = (float*)d_out; a.ws = (unsigned char*)d_ws;
    for (int li = 0; li < N_LAUNCHES; ++li) {
        a.ph_lo = (N_LAUNCHES == PER_PHASE) ? li : 0; a.ph_hi = (N_LAUNCHES == PER_PHASE) ? li + 1 : PER_PHASE;
        hipLaunchKernelGGL(mk_fwd, dim3(grid), dim3(NWAVES * 64), LDS_BYTES, stream, a);
        const hipError_t le = hipPeekAtLastError();
        if (le != hipSuccess) { fprintf(stderr, "kernel_launch: launch %d failed: %s\n", li, hipGetErrorName(le)); break; }
    }
}
```
